# Optimizing an MI355X kernel written in HIP

```python
import math
import jax, jax.numpy as jnp
from jax import lax
import numpy as np

D_MODEL = 1024
BATCH = 2
SEQ = 8192
DEPTH = 2

N_MEM = 256
CONV_WIDTH = D_MODEL // 2
CONV_KSIZE = 31
ATT_PATTERNS = ((128, 1), (512, 4), (2048, 16))
N_GROUPS = len(ATT_PATTERNS)
HEADS_PER_GROUP = 4
ATT_HEAD_DIM = D_MODEL // 16
N_ATT_HEADS = N_GROUPS * HEADS_PER_GROUP
ATT_WIDTH = N_ATT_HEADS * ATT_HEAD_DIM
ATT_OUT_WIDTH = HEADS_PER_GROUP * ATT_HEAD_DIM
MEM_HEADS = 4
MEM_HEAD_DIM = D_MODEL // 8
MEM_WIDTH = MEM_HEADS * MEM_HEAD_DIM
N_BRANCHES = 3
IN_WIDTH = 2 * CONV_WIDTH + 3 * ATT_WIDTH + MEM_WIDTH + N_BRANCHES * D_MODEL
FFN_HIDDEN = -(-(8 * D_MODEL) // (3 * 256)) * 256
NUM_BUCKETS = 32
MAX_DISTANCE = 1024
RMS_EPS = 1e-6
LN_EPS = 1e-5
NEG_INF = -1e30

kernel_name = "hybrid_gated_conv_dilated_memory_encoder"


def _rms_norm(x, g):
    xf = x.astype(jnp.float32)
    y = xf * lax.rsqrt(jnp.mean(xf * xf, axis=-1, keepdims=True) + RMS_EPS)
    return (y * g.astype(jnp.float32)).astype(x.dtype)


def _layer_norm(x, g, b):
    xf = x.astype(jnp.float32)
    mu = jnp.mean(xf, axis=-1, keepdims=True)
    xc = xf - mu
    y = xc * lax.rsqrt(jnp.mean(xc * xc, axis=-1, keepdims=True) + LN_EPS)
    return (y * g.astype(jnp.float32) + b.astype(jnp.float32)).astype(x.dtype)


def _t5_bucket(rel):
    nb = NUM_BUCKETS // 2
    max_exact = nb // 2
    ret = jnp.where(rel > 0, nb, 0)
    n = jnp.abs(rel)
    nf = jnp.maximum(n, 1).astype(jnp.float32)
    large = max_exact + (jnp.log(nf / max_exact) / math.log(MAX_DISTANCE / max_exact)
                         * (nb - max_exact)).astype(jnp.int32)
    large = jnp.minimum(large, nb - 1)
    return ret + jnp.where(n < max_exact, n, large)


def _dilated_group(q, k, v, bias_tab, dilation, radius):
    B, S, H, E = q.shape
    blk = radius
    unit = dilation * blk
    sp = -(-S // unit) * unit
    L = sp // dilation
    nb = L // blk

    def to_blocks(t):
        t = jnp.pad(t, ((0, 0), (0, sp - S), (0, 0), (0, 0)))
        t = t.reshape(B, L, dilation, H, E).transpose(0, 2, 1, 3, 4)
        return t.reshape(B, dilation, nb, blk, H, E)

    def band_keys(t):
        tp = jnp.pad(t, ((0, 0), (0, 0), (1, 1), (0, 0), (0, 0), (0, 0)))
        return jnp.concatenate([tp[:, :, :-2], tp[:, :, 1:-1], tp[:, :, 2:]], axis=3)

    qb = to_blocks(q)
    kb = band_keys(to_blocks(k))
    vb = band_keys(to_blocks(v))
    valid = (jnp.arange(sp) < S).reshape(L, dilation).T.reshape(dilation, nb, blk)
    vp = jnp.pad(valid, ((0, 0), (1, 1), (0, 0)))
    kvalid = jnp.concatenate([vp[:, :-2], vp[:, 1:-1], vp[:, 2:]], axis=2)

    s = jnp.einsum('brnqhe,brnkhe->brnhqk', qb, kb).astype(jnp.float32) * (E ** -0.5)
    off = jnp.arange(3 * blk)[None, :] - blk - jnp.arange(blk)[:, None]
    band = jnp.abs(off) <= radius
    bias = bias_tab[_t5_bucket(off * dilation)].transpose(2, 0, 1).astype(jnp.float32)
    mask = band & kvalid[:, :, None, None, :]
    s = jnp.where(mask, s + bias, NEG_INF)
    m = jnp.max(s, axis=-1, keepdims=True)
    e = jnp.exp(s - m)
    den = jnp.sum(e, axis=-1, keepdims=True)
    lse = (m + jnp.log(den))[..., 0]
    o = jnp.einsum('brnhqk,brnkhe->brnqhe', (e / den).astype(v.dtype), vb)

    def from_blocks(t):
        tail = t.shape[4:]
        t = t.reshape(B, dilation, L, *tail).swapaxes(1, 2).reshape(B, sp, *tail)
        return t[:, :S]

    return from_blocks(o), from_blocks(lse.transpose(0, 1, 2, 4, 3))


def _dilated_attention(att_in, rel_bias):
    B, S, _ = att_in.shape
    qkv = att_in.reshape(B, S, 3, N_GROUPS, HEADS_PER_GROUP, ATT_HEAD_DIM)
    outs, lses = [], []
    for g, (window, dilation) in enumerate(ATT_PATTERNS):
        radius = window // (2 * dilation)
        tab = rel_bias[:, g * HEADS_PER_GROUP:(g + 1) * HEADS_PER_GROUP]
        o, l = _dilated_group(qkv[:, :, 0, g], qkv[:, :, 1, g], qkv[:, :, 2, g], tab, dilation, radius)
        outs.append(o)
        lses.append(l)
    w = jax.nn.softmax(jnp.stack(lses, axis=0), axis=0)
    o = jnp.sum(w[..., None].astype(outs[0].dtype) * jnp.stack(outs, axis=0), axis=0)
    return o.reshape(B, S, ATT_OUT_WIDTH)


def _conv_module(u, w_dw, b_dw, ln_g, ln_b, w_o):
    a, gt = jnp.split(u, 2, axis=-1)
    u = a * jax.nn.sigmoid(gt)
    pad = CONV_KSIZE // 2
    y = lax.conv_general_dilated(u, w_dw[:, None, :], window_strides=(1,), padding=((pad, pad),),
                                 dimension_numbers=('NWC', 'WIO', 'NWC'),
                                 feature_group_count=CONV_WIDTH) + b_dw
    y = jax.nn.silu(_layer_norm(y, ln_g, ln_b))
    return y @ w_o


def _memory_attention(q_in, mem, g_mem, w_kv, w_o):
    B, S, _ = q_in.shape
    M = mem.shape[1]
    q = q_in.reshape(B, S, MEM_HEADS, MEM_HEAD_DIM)
    kv = (_rms_norm(mem, g_mem) @ w_kv).reshape(B, M, 2, MEM_HEADS, MEM_HEAD_DIM)
    k, v = kv[:, :, 0], kv[:, :, 1]
    s = jnp.einsum('bshe,bmhe->bhsm', q, k).astype(jnp.float32) * (MEM_HEAD_DIM ** -0.5)
    p = jax.nn.softmax(s, axis=-1).astype(v.dtype)
    o = jnp.einsum('bhsm,bmhe->bshe', p, v).reshape(B, S, MEM_WIDTH)
    return o @ w_o


def setup_inputs(seed: int = 0) -> dict:
    key = jax.random.key(seed)
    ks = jax.random.split(key, 24)
    f32 = jnp.float32

    def nrm(k, shape, scale):
        return jax.random.normal(k, shape, f32) * scale

    def gain(k, shape):
        return 1.0 + 0.05 * jax.random.normal(k, shape, f32)

    return {
        "x": jax.random.normal(ks[0], (BATCH, SEQ, D_MODEL), f32),
        "mem": jax.random.normal(ks[1], (BATCH, N_MEM, D_MODEL), f32),
        "rel_bias": nrm(ks[2], (NUM_BUCKETS, N_ATT_HEADS), 0.5),
        "norm_mix_pre": gain(ks[3], (DEPTH, D_MODEL)),
        "w_in": nrm(ks[4], (DEPTH, D_MODEL, IN_WIDTH), D_MODEL ** -0.5),
        "b_gate": nrm(ks[5], (DEPTH, N_BRANCHES * D_MODEL), 0.01),
        "conv_dw": nrm(ks[6], (DEPTH, CONV_KSIZE, CONV_WIDTH), CONV_KSIZE ** -0.5),
        "conv_dw_bias": nrm(ks[7], (DEPTH, CONV_WIDTH), 0.02),
        "conv_ln_g": gain(ks[8], (DEPTH, CONV_WIDTH)),
        "conv_ln_b": nrm(ks[9], (DEPTH, CONV_WIDTH), 0.02),
        "w_conv_out": nrm(ks[10], (DEPTH, CONV_WIDTH, D_MODEL), CONV_WIDTH ** -0.5),
        "w_att_out": nrm(ks[11], (DEPTH, ATT_OUT_WIDTH, D_MODEL), ATT_OUT_WIDTH ** -0.5),
        "norm_mem": gain(ks[12], (DEPTH, D_MODEL)),
        "w_mem_kv": nrm(ks[13], (DEPTH, D_MODEL, 2 * MEM_WIDTH), D_MODEL ** -0.5),
        "w_mem_out": nrm(ks[14], (DEPTH, MEM_WIDTH, D_MODEL), MEM_WIDTH ** -0.5),
        "w_out": nrm(ks[15], (DEPTH, D_MODEL, D_MODEL), D_MODEL ** -0.5),
        "norm_mix_post": gain(ks[16], (DEPTH, D_MODEL)),
        "norm_ffn_pre": gain(ks[17], (DEPTH, D_MODEL)),
        "w_ffn_in": nrm(ks[18], (DEPTH, D_MODEL, 2 * FFN_HIDDEN), D_MODEL ** -0.5),
        "w_ffn_out": nrm(ks[19], (DEPTH, FFN_HIDDEN, D_MODEL), FFN_HIDDEN ** -0.5),
        "norm_ffn_post": gain(ks[20], (DEPTH, D_MODEL)),
    }


def reference(x, mem, rel_bias, norm_mix_pre, w_in, b_gate, conv_dw, conv_dw_bias, conv_ln_g,
              conv_ln_b, w_conv_out, w_att_out, norm_mem, w_mem_kv, w_mem_out, w_out,
              norm_mix_post, norm_ffn_pre, w_ffn_in, w_ffn_out, norm_ffn_post):
    B, S, _ = x.shape
    c1 = 2 * CONV_WIDTH
    c2 = c1 + 3 * ATT_WIDTH
    c3 = c2 + MEM_WIDTH
    for l in range(DEPTH):
        h = _rms_norm(x, norm_mix_pre[l])
        z = h @ w_in[l]
        y_conv = _conv_module(z[..., :c1], conv_dw[l], conv_dw_bias[l], conv_ln_g[l],
                              conv_ln_b[l], w_conv_out[l])
        y_att = _dilated_attention(z[..., c1:c2], rel_bias) @ w_att_out[l]
        y_mem = _memory_attention(z[..., c2:c3], mem, norm_mem[l], w_mem_kv[l], w_mem_out[l])
        gates = jax.nn.sigmoid(z[..., c3:] + b_gate[l]).reshape(B, S, N_BRANCHES, D_MODEL)
        merged = gates[:, :, 0] * y_conv + gates[:, :, 1] * y_att + gates[:, :, 2] * y_mem
        x = x + _rms_norm(merged @ w_out[l], norm_mix_post[l])
        h = _rms_norm(x, norm_ffn_pre[l])
        gu = h @ w_ffn_in[l]
        g_ff, u_ff = gu[..., :FFN_HIDDEN], gu[..., FFN_HIDDEN:]
        x = x + _rms_norm((jax.nn.silu(g_ff) * u_ff) @ w_ffn_out[l], norm_ffn_post[l])
    return x
```

```cpp
#include <hip/hip_runtime.h>
#include <cstdio>
#include <cstdint>

namespace nv {
constexpr int D = 1024, BATCH = 2, SEQ = 8192, NMEM = 256, CW = 512, KS = 31;
constexpr int AW = 768, AOW = 256, MW = 512, INW = 6912, FH = 2816;
constexpr int C1 = 1024, C2 = 3328, C3 = 3840;

__device__ __forceinline__ float wsum(float v) {
#pragma unroll
    for (int o = 1; o < 64; o <<= 1) v += __shfl_xor(v, o);
    return v;
}
__device__ __forceinline__ float wmax(float v) {
#pragma unroll
    for (int o = 1; o < 64; o <<= 1) v = fmaxf(v, __shfl_xor(v, o));
    return v;
}
__device__ __forceinline__ float sigm(float v) { return 1.f / (1.f + expf(-v)); }

__global__ void k_rms(const float* x, const float* g, float* out, int rows) {
    const int w = (blockIdx.x * blockDim.x + threadIdx.x) >> 6, lane = threadIdx.x & 63;
    if (w >= rows) return;
    const float* xr = x + (size_t)w * D; float v[16]; float s = 0.f;
#pragma unroll
    for (int i = 0; i < 16; ++i) { v[i] = xr[lane + 64 * i]; s += v[i] * v[i]; }
    const float rs = rsqrtf(wsum(s) * (1.f / D) + 1e-6f);
#pragma unroll
    for (int i = 0; i < 16; ++i) out[(size_t)w * D + lane + 64 * i] = v[i] * rs * g[lane + 64 * i];
}
__global__ void k_res_rms(float* x, const float* y, const float* g, int rows) {
    const int w = (blockIdx.x * blockDim.x + threadIdx.x) >> 6, lane = threadIdx.x & 63;
    if (w >= rows) return;
    const float* yr = y + (size_t)w * D; float v[16]; float s = 0.f;
#pragma unroll
    for (int i = 0; i < 16; ++i) { v[i] = yr[lane + 64 * i]; s += v[i] * v[i]; }
    const float rs = rsqrtf(wsum(s) * (1.f / D) + 1e-6f);
#pragma unroll
    for (int i = 0; i < 16; ++i) x[(size_t)w * D + lane + 64 * i] += v[i] * rs * g[lane + 64 * i];
}
__global__ void __launch_bounds__(256) k_gemm(const float* A, int lda, const float* B, int ldb, float* C, int ldc, int K, int mode) {
    __shared__ float As[8][128 + 4];
    __shared__ float Bs[8][128 + 4];
    const int tid = threadIdx.x, tx = tid & 15, ty = tid >> 4;
    const int m0 = blockIdx.y * 128, n0 = blockIdx.x * 128;
    float acc[8][8];
#pragma unroll
    for (int i = 0; i < 8; ++i)
#pragma unroll
        for (int j = 0; j < 8; ++j) acc[i][j] = 0.f;
    for (int k0 = 0; k0 < K; k0 += 8) {
#pragma unroll
        for (int i = 0; i < 4; ++i) { const int e = tid + 256 * i, r = e >> 3, kk = e & 7; As[kk][r] = A[(size_t)(m0 + r) * lda + k0 + kk]; }
#pragma unroll
        for (int i = 0; i < 4; ++i) { const int e = tid + 256 * i, kk = e >> 7, c = e & 127; Bs[kk][c] = B[(size_t)(k0 + kk) * ldb + n0 + c]; }
        __syncthreads();
#pragma unroll
        for (int kk = 0; kk < 8; ++kk) {
            float a[8], b[8];
#pragma unroll
            for (int i = 0; i < 8; ++i) a[i] = As[kk][ty * 8 + i];
#pragma unroll
            for (int j = 0; j < 8; ++j) b[j] = Bs[kk][tx * 8 + j];
#pragma unroll
            for (int i = 0; i < 8; ++i)
#pragma unroll
                for (int j = 0; j < 8; ++j) acc[i][j] = fmaf(a[i], b[j], acc[i][j]);
        }
        __syncthreads();
    }
#pragma unroll
    for (int i = 0; i < 8; ++i)
#pragma unroll
        for (int j = 0; j < 8; ++j) {
            float* p = C + (size_t)(m0 + ty * 8 + i) * ldc + n0 + tx * 8 + j;
            if (mode == 0) *p = acc[i][j];
            else { const float gv = *p; *p = gv * sigm(gv) * acc[i][j]; }
        }
}
__global__ void k_conv(const float* zc, const float* wdw, const float* bdw, const float* lng, const float* lnb, float* cv, int S) {
    const int t = (blockIdx.x * blockDim.x + threadIdx.x) >> 6, lane = threadIdx.x & 63;
    if (t >= S) return;
    float y[8];
#pragma unroll
    for (int i = 0; i < 8; ++i) y[i] = bdw[lane + 64 * i];
    for (int j = 0; j < KS; ++j) {
        const int tt = t + j - 15; if (tt < 0 || tt >= S) continue;
        const float* zr = zc + (size_t)tt * 1024;
#pragma unroll
        for (int i = 0; i < 8; ++i) { const int c = lane + 64 * i; const float a = zr[c], gt = zr[512 + c]; y[i] = fmaf(a * sigm(gt), wdw[j * CW + c], y[i]); }
    }
    float s = 0.f;
#pragma unroll
    for (int i = 0; i < 8; ++i) s += y[i];
    const float mu = wsum(s) * (1.f / CW); float q = 0.f;
#pragma unroll
    for (int i = 0; i < 8; ++i) { y[i] -= mu; q += y[i] * y[i]; }
    const float rs = rsqrtf(wsum(q) * (1.f / CW) + 1e-5f);
#pragma unroll
    for (int i = 0; i < 8; ++i) { const int c = lane + 64 * i; const float v = y[i] * rs * lng[c] + lnb[c]; cv[(size_t)t * CW + c] = v * sigm(v); }
}
__device__ __forceinline__ int t5bucket(int rel) {
    const int n = rel < 0 ? -rel : rel; int b;
    if (n < 8) b = n; else { b = 8 + (n >= 15) + (n >= 27) + (n >= 50) + (n >= 91) + (n >= 166) + (n >= 305) + (n >= 559); }
    return b + (rel > 0 ? 16 : 0);
}
__global__ void k_datt(const float* qkv, const float* relb, float* att, int S) {
    const int w = (blockIdx.x * blockDim.x + threadIdx.x) >> 6, lane = threadIdx.x & 63;
    if (w >= S * 4) return;
    const int p = w >> 2, h = w & 3;
    float og[3], lse[3];
    for (int g = 0; g < 3; ++g) {
        const int d = g == 0 ? 1 : (g == 1 ? 4 : 16), L = S / d, r = p % d, m = p / d;
        const float* q = qkv + (size_t)p * 2304 + g * 256 + h * 64;
        float sc[3]; int key[3]; bool act[3];
#pragma unroll
        for (int ps = 0; ps < 3; ++ps) {
            const int off = ps * 64 + lane - 64, mk = m + off;
            act[ps] = (off <= 64) && mk >= 0 && mk < L;
            key[ps] = act[ps] ? mk * d + r : p;
            const float* k = qkv + (size_t)key[ps] * 2304 + 768 + g * 256 + h * 64;
            float dot = 0.f;
            for (int e = 0; e < 64; ++e) dot = fmaf(q[e], k[e], dot);
            sc[ps] = act[ps] ? dot * 0.125f + relb[t5bucket(off * d) * 12 + g * 4 + h] : -1e30f;
        }
        const float mx = wmax(fmaxf(fmaxf(sc[0], sc[1]), sc[2]));
        float e0 = act[0] ? expf(sc[0] - mx) : 0.f, e1 = act[1] ? expf(sc[1] - mx) : 0.f, e2 = act[2] ? expf(sc[2] - mx) : 0.f;
        const float den = wsum(e0 + e1 + e2);
        lse[g] = mx + logf(den);
        const float pr[3] = {e0 / den, e1 / den, e2 / den};
        float o = 0.f;
#pragma unroll
        for (int ps = 0; ps < 3; ++ps)
            for (int j = 0; j < 64; ++j) {
                const float pj = __shfl(pr[ps], j); const int kj = __shfl(key[ps], j);
                if (pj != 0.f) o = fmaf(pj, qkv[(size_t)kj * 2304 + 1536 + g * 256 + h * 64 + lane], o);
            }
        og[g] = o;
    }
    const float mx = fmaxf(fmaxf(lse[0], lse[1]), lse[2]);
    const float w0 = expf(lse[0] - mx), w1 = expf(lse[1] - mx), w2 = expf(lse[2] - mx), ws = w0 + w1 + w2;
    att[(size_t)p * 256 + h * 64 + lane] = (w0 * og[0] + w1 * og[1] + w2 * og[2]) / ws;
}
__global__ void k_matt(const float* mq, const float* kv, float* mo, int S) {
    const int w = (blockIdx.x * blockDim.x + threadIdx.x) >> 6, lane = threadIdx.x & 63;
    if (w >= S * 4) return;
    const int p = w >> 2, h = w & 3;
    const float* q = mq + (size_t)p * 512 + h * 128;
    float sc[4];
#pragma unroll
    for (int i = 0; i < 4; ++i) { const float* k = kv + (size_t)(lane + 64 * i) * 1024 + h * 128; float dot = 0.f; for (int e = 0; e < 128; ++e) dot = fmaf(q[e], k[e], dot); sc[i] = dot * 0.08838834764831845f; }
    const float mx = wmax(fmaxf(fmaxf(sc[0], sc[1]), fmaxf(sc[2], sc[3])));
    float e[4]; float s = 0.f;
#pragma unroll
    for (int i = 0; i < 4; ++i) { e[i] = expf(sc[i] - mx); s += e[i]; }
    const float den = wsum(s);
    float o0 = 0.f, o1 = 0.f;
#pragma unroll
    for (int i = 0; i < 4; ++i)
        for (int j = 0; j < 64; ++j) { const float pj = __shfl(e[i], j) / den; const float* v = kv + (size_t)(j + 64 * i) * 1024 + 512 + h * 128; o0 = fmaf(pj, v[lane], o0); o1 = fmaf(pj, v[lane + 64], o1); }
    mo[(size_t)p * 512 + h * 128 + lane] = o0; mo[(size_t)p * 512 + h * 128 + lane + 64] = o1;
}
__global__ void k_gate(float* merged, const float* zg, const float* b, const float* y, size_t n, int first) {
    const size_t i = (size_t)blockIdx.x * blockDim.x + threadIdx.x; if (i >= n) return;
    const float v = sigm(zg[i] + b[i & 1023]) * y[i];
    merged[i] = first ? v : merged[i] + v;
}
}

extern "C" void kernel_launch(void* const* d_in, const int* in_sizes, int n_in, void* d_out, int out_size, void* d_ws, size_t ws_size, hipStream_t stream) {
    using namespace nv;
    const float* x_in = (const float*)d_in[0]; const float* mem = (const float*)d_in[1]; const float* relb = (const float*)d_in[2];
    const float* nmp = (const float*)d_in[3]; const float* w_in = (const float*)d_in[4]; const float* b_gate = (const float*)d_in[5];
    const float* cdw = (const float*)d_in[6]; const float* cdb = (const float*)d_in[7]; const float* clg = (const float*)d_in[8]; const float* clb = (const float*)d_in[9];
    const float* wco = (const float*)d_in[10]; const float* wao = (const float*)d_in[11]; const float* nmem = (const float*)d_in[12]; const float* wkv = (const float*)d_in[13];
    const float* wmo = (const float*)d_in[14]; const float* wout = (const float*)d_in[15]; const float* nmpost = (const float*)d_in[16]; const float* nfpre = (const float*)d_in[17];
    const float* wfi = (const float*)d_in[18]; const float* wfo = (const float*)d_in[19]; const float* nfpost = (const float*)d_in[20];
    float* x = (float*)d_out;
    const size_t MB = 1u << 20;
    char* ws = (char*)d_ws;
    float* h = (float*)(ws + 0 * MB);
    float* cv = (float*)(ws + 32 * MB);
    float* att = (float*)(ws + 48 * MB);
    float* mo = (float*)(ws + 56 * MB);
    float* kvb = (float*)(ws + 72 * MB);
    float* hm = (float*)(ws + 73 * MB);
    float* big = (float*)(ws + 76 * MB);
    float* merged = (float*)(ws + 170 * MB);
    float* yb = (float*)(ws + 204 * MB);
    const int S = SEQ;
    hipMemcpyAsync(x, x_in, (size_t)BATCH * SEQ * D * 4, hipMemcpyDeviceToDevice, stream);
    for (int l = 0; l < 2; ++l) {
        const float* Win = w_in + (size_t)l * D * INW;
        for (int b = 0; b < BATCH; ++b) {
            float* xb = x + (size_t)b * S * D;
            k_rms<<<S / 4, 256, 0, stream>>>(xb, nmp + l * D, h, S);
            k_gemm<<<dim3(1024 / 128, S / 128), 256, 0, stream>>>(h, D, Win + 0, INW, big, 1024, D, 0);
            k_conv<<<S / 4, 256, 0, stream>>>(big, cdw + l * KS * CW, cdb + l * CW, clg + l * CW, clb + l * CW, cv, S);
            k_gemm<<<dim3(2304 / 128, S / 128), 256, 0, stream>>>(h, D, Win + C1, INW, big, 2304, D, 0);
            k_datt<<<S * 4 / 4, 256, 0, stream>>>(big, relb, att, S);
            k_rms<<<NMEM / 4, 256, 0, stream>>>(mem + (size_t)b * NMEM * D, nmem + l * D, hm, NMEM);
            k_gemm<<<dim3(1024 / 128, NMEM / 128), 256, 0, stream>>>(hm, D, wkv + (size_t)l * D * 1024, 1024, kvb, 1024, D, 0);
            k_gemm<<<dim3(512 / 128, S / 128), 256, 0, stream>>>(h, D, Win + C2, INW, big, 512, D, 0);
            k_matt<<<S * 4 / 4, 256, 0, stream>>>(big, kvb, mo, S);
            float* y = big; float* zg = big + (size_t)S * D;
            const size_t n = (size_t)S * D;
            k_gemm<<<dim3(1024 / 128, S / 128), 256, 0, stream>>>(cv, CW, wco + (size_t)l * CW * D, D, y, D, CW, 0);
            k_gemm<<<dim3(1024 / 128, S / 128), 256, 0, stream>>>(h, D, Win + C3, INW, zg, D, D, 0);
            k_gate<<<(unsigned)(n / 256), 256, 0, stream>>>(merged, zg, b_gate + l * 3072, y, n, 1);
            k_gemm<<<dim3(1024 / 128, S / 128), 256, 0, stream>>>(att, AOW, wao + (size_t)l * AOW * D, D, y, D, AOW, 0);
            k_gemm<<<dim3(1024 / 128, S / 128), 256, 0, stream>>>(h, D, Win + C3 + 1024, INW, zg, D, D, 0);
            k_gate<<<(unsigned)(n / 256), 256, 0, stream>>>(merged, zg, b_gate + l * 3072 + 1024, y, n, 0);
            k_gemm<<<dim3(1024 / 128, S / 128), 256, 0, stream>>>(mo, MW, wmo + (size_t)l * MW * D, D, y, D, MW, 0);
            k_gemm<<<dim3(1024 / 128, S / 128), 256, 0, stream>>>(h, D, Win + C3 + 2048, INW, zg, D, D, 0);
            k_gate<<<(unsigned)(n / 256), 256, 0, stream>>>(merged, zg, b_gate + l * 3072 + 2048, y, n, 0);
            k_gemm<<<dim3(1024 / 128, S / 128), 256, 0, stream>>>(merged, D, wout + (size_t)l * D * D, D, yb, D, D, 0);
            k_res_rms<<<S / 4, 256, 0, stream>>>(xb, yb, nmpost + l * D, S);
            k_rms<<<S / 4, 256, 0, stream>>>(xb, nfpre + l * D, h, S);
            const float* Wf = wfi + (size_t)l * D * 2 * FH;
            k_gemm<<<dim3(FH / 128, S / 128), 256, 0, stream>>>(h, D, Wf, 2 * FH, big, FH, D, 0);
            k_gemm<<<dim3(FH / 128, S / 128), 256, 0, stream>>>(h, D, Wf + FH, 2 * FH, big, FH, D, 1);
            k_gemm<<<dim3(1024 / 128, S / 128), 256, 0, stream>>>(big, FH, wfo + (size_t)l * FH * D, D, yb, D, FH, 0);
            k_res_rms<<<S / 4, 256, 0, stream>>>(xb, yb, nfpost + l * D, S);
        }
    }
}
```
